# Optimizing an MI355X kernel written in HIP

```python
import math
import jax
import jax.numpy as jnp
from jax import lax
import numpy as np

D_MODEL = 1024
BATCH = 8
SEQ = 4096
DEPTH = 1

SG_GROUPS = 8
SG_GROUP_DIM = 128
SG_WIDTH = SG_GROUPS * SG_GROUP_DIM
SG_CHUNK = 128
MOBA_HEADS = 8
MOBA_HEAD_DIM = 128
MOBA_WIDTH = MOBA_HEADS * MOBA_HEAD_DIM
MOBA_BLOCK = 256
MOBA_TOPK = 3
MOBA_QCHUNK = 16
REL_BUCKETS = 32
REL_MAX_DIST = 128
D_FF = 2816
MACARON_WEIGHT = 0.5
IN_WIDTH = 2 * SG_WIDTH + 3 * MOBA_WIDTH + 2 * D_MODEL
DEEPNORM_ALPHA = (2.0 * DEPTH) ** 0.25
DEEPNORM_BETA = (8.0 * DEPTH) ** -0.25
LN_EPS = 1e-5
NEG_INF = -1e30

kernel_name = 'hybrid_gmlp_moba_macaron_deepnorm'


def layer_norm(x, g, b):
    xf = x.astype(jnp.float32)
    mu = jnp.mean(xf, axis=-1, keepdims=True)
    var = jnp.mean(jnp.square(xf - mu), axis=-1, keepdims=True)
    y = (xf - mu) * lax.rsqrt(var + LN_EPS) * g.astype(jnp.float32) + b.astype(jnp.float32)
    return y.astype(x.dtype)


def swiglu_ffn(x, w_gate, w_up, w_down):
    return (jax.nn.silu(x @ w_gate) * (x @ w_up)) @ w_down


def rel_bucket(dist):
    n = jnp.maximum(dist, 0)
    max_exact = REL_BUCKETS // 2
    nf = jnp.maximum(n, 1).astype(jnp.float32)
    large = max_exact + (jnp.log(nf / max_exact) / math.log(REL_MAX_DIST / max_exact)
                         * (REL_BUCKETS - max_exact)).astype(jnp.int32)
    large = jnp.minimum(large, REL_BUCKETS - 1)
    return jnp.where(n < max_exact, n, large)


def spatial_gating(u, v, ln_g, ln_b, w_s, b_s):
    bsz, seq, _ = v.shape
    n_chunks = seq // SG_CHUNK
    v = layer_norm(v, ln_g, ln_b)
    vc = v.reshape(bsz, n_chunks, SG_CHUNK, SG_GROUPS, SG_GROUP_DIM)
    causal = jnp.tril(jnp.ones((SG_CHUNK, SG_CHUNK), dtype=bool))
    w = jnp.where(causal[None], w_s, jnp.zeros_like(w_s))
    mixed = jnp.einsum('gts,bnsgc->bntgc', w, vc) + b_s.T[None, None, :, :, None]
    return u * mixed.reshape(bsz, seq, SG_WIDTH)


def moba_attention(q, k, v, rel_table):
    bsz, n_heads, seq, hd = q.shape
    n_blocks = -(-seq // MOBA_BLOCK)
    seq_pad = n_blocks * MOBA_BLOCK
    pad = ((0, 0), (0, 0), (0, seq_pad - seq), (0, 0))
    q, k, v = jnp.pad(q, pad), jnp.pad(k, pad), jnp.pad(v, pad)
    topk = min(MOBA_TOPK, n_blocks)
    scale = hd ** -0.5
    k_blk = k.reshape(bsz, n_heads, n_blocks, MOBA_BLOCK, hd)
    v_blk = v.reshape(bsz, n_heads, n_blocks, MOBA_BLOCK, hd)

    pos = jnp.arange(seq_pad, dtype=jnp.int32)
    q_block = pos // MOBA_BLOCK
    k_mean = jnp.mean(k_blk.astype(jnp.float32), axis=3)
    gate = jnp.einsum('bhsd,bhnd->bhsn', q.astype(jnp.float32), k_mean)
    fully_past = jnp.arange(n_blocks, dtype=jnp.int32)[None, :] < q_block[:, None]
    gate = jnp.where(fully_past, gate, NEG_INF)
    _, sel = lax.top_k(gate, topk)

    n_q = seq_pad // MOBA_QCHUNK
    q_c = q.reshape(bsz, n_heads, n_q, MOBA_QCHUNK, hd).transpose(2, 0, 1, 3, 4)
    sel_c = sel.reshape(bsz, n_heads, n_q, MOBA_QCHUNK, topk).transpose(2, 0, 1, 3, 4)
    table_t = rel_table.T.astype(jnp.float32)
    b_idx = jnp.arange(bsz)[:, None, None, None]
    h_idx = jnp.arange(n_heads)[None, :, None, None]
    h_idx5 = h_idx[..., None]
    offs = jnp.arange(MOBA_BLOCK, dtype=jnp.int32)

    def attend_chunk(args):
        ci, qc, selc = args
        t = ci * MOBA_QCHUNK + jnp.arange(MOBA_QCHUNK, dtype=jnp.int32)
        own = (ci * MOBA_QCHUNK) // MOBA_BLOCK
        k_own = lax.dynamic_index_in_dim(k_blk, own, axis=2, keepdims=False)
        v_own = lax.dynamic_index_in_dim(v_blk, own, axis=2, keepdims=False)
        d_own = t[:, None] - (own * MOBA_BLOCK + offs)[None, :]
        l_own = (jnp.einsum('bhqd,bhjd->bhqj', qc, k_own).astype(jnp.float32) * scale
                 + table_t[:, rel_bucket(d_own)][None])
        l_own = jnp.where((d_own >= 0)[None, None], l_own, NEG_INF)
        k_sel = k_blk[b_idx, h_idx, selc]
        v_sel = v_blk[b_idx, h_idx, selc]
        d_sel = t[None, None, :, None, None] - (selc[..., None] * MOBA_BLOCK + offs)
        l_sel = (jnp.einsum('bhqd,bhqkjd->bhqkj', qc, k_sel).astype(jnp.float32) * scale
                 + table_t[h_idx5, rel_bucket(d_sel)])
        slot_ok = jnp.arange(topk, dtype=jnp.int32)[None, :] < (t // MOBA_BLOCK)[:, None]
        l_sel = jnp.where(slot_ok[None, None, :, :, None], l_sel, NEG_INF)
        logits = jnp.concatenate(
            [l_sel.reshape(bsz, n_heads, MOBA_QCHUNK, topk * MOBA_BLOCK), l_own], axis=-1)
        p = jax.nn.softmax(logits, axis=-1).astype(v.dtype)
        p_sel = p[..., :topk * MOBA_BLOCK].reshape(bsz, n_heads, MOBA_QCHUNK, topk, MOBA_BLOCK)
        p_own = p[..., topk * MOBA_BLOCK:]
        return (jnp.einsum('bhqkj,bhqkjd->bhqd', p_sel, v_sel)
                + jnp.einsum('bhqj,bhjd->bhqd', p_own, v_own))

    out = lax.map(attend_chunk, (jnp.arange(n_q, dtype=jnp.int32), q_c, sel_c))
    out = out.transpose(1, 2, 0, 3, 4).reshape(bsz, n_heads, seq_pad, hd)
    return out[:, :, :seq]


def token_mixer(h, w_in, sg_ln_g, sg_ln_b, sg_w_s, sg_b_s, rel_table, w_proj_a, w_proj_b, w_out):
    bsz, seq, _ = h.shape
    z = h @ w_in
    o1 = 2 * SG_WIDTH
    o2 = o1 + 3 * MOBA_WIDTH
    uv = jax.nn.gelu(z[..., :o1])
    y_a = spatial_gating(uv[..., :SG_WIDTH], uv[..., SG_WIDTH:], sg_ln_g, sg_ln_b, sg_w_s, sg_b_s)
    qkv = z[..., o1:o2].reshape(bsz, seq, 3, MOBA_HEADS, MOBA_HEAD_DIM).transpose(2, 0, 3, 1, 4)
    y_b = moba_attention(qkv[0], qkv[1], qkv[2], rel_table)
    y_b = y_b.transpose(0, 2, 1, 3).reshape(bsz, seq, MOBA_WIDTH)
    gates = jax.nn.sigmoid(z[..., o2:])
    merged = gates[..., :D_MODEL] * (y_a @ w_proj_a) + gates[..., D_MODEL:] * (y_b @ w_proj_b)
    return merged @ w_out


def setup_inputs(seed: int = 0) -> dict:
    key = jax.random.key(seed)
    ks = jax.random.split(key, 26)
    L = DEPTH

    def nrm(k, shape, scale):
        return jax.random.normal(k, shape, jnp.float32) * scale

    d_in = D_MODEL ** -0.5
    beta = DEEPNORM_BETA
    x = nrm(ks[0], (BATCH, SEQ, D_MODEL), 1.0)
    ffn1_w_gate = nrm(ks[1], (L, D_MODEL, D_FF), d_in)
    ffn1_w_up = nrm(ks[2], (L, D_MODEL, D_FF), d_in * beta)
    ffn1_w_down = nrm(ks[3], (L, D_FF, D_MODEL), D_FF ** -0.5 * beta)
    ln1_g = 1.0 + nrm(ks[4], (L, D_MODEL), 0.02)
    ln1_b = nrm(ks[5], (L, D_MODEL), 0.02)
    w_in = jnp.concatenate([
        nrm(ks[6], (L, D_MODEL, 2 * SG_WIDTH), d_in),
        nrm(ks[7], (L, D_MODEL, 2 * MOBA_WIDTH), d_in),
        nrm(ks[8], (L, D_MODEL, MOBA_WIDTH), d_in * beta),
        nrm(ks[9], (L, D_MODEL, 2 * D_MODEL), d_in),
    ], axis=-1)
    sg_ln_g = 1.0 + nrm(ks[10], (L, SG_WIDTH), 0.02)
    sg_ln_b = nrm(ks[11], (L, SG_WIDTH), 0.02)
    sg_w_s = nrm(ks[12], (L, SG_GROUPS, SG_CHUNK, SG_CHUNK), SG_CHUNK ** -0.5)
    sg_b_s = 1.0 + nrm(ks[13], (L, SG_GROUPS, SG_CHUNK), 0.02)
    rel_table = nrm(ks[14], (REL_BUCKETS, MOBA_HEADS), 0.1)
    w_proj_a = nrm(ks[15], (L, SG_WIDTH, D_MODEL), SG_WIDTH ** -0.5 * beta)
    w_proj_b = nrm(ks[16], (L, MOBA_WIDTH, D_MODEL), MOBA_WIDTH ** -0.5 * beta)
    w_out = nrm(ks[17], (L, D_MODEL, D_MODEL), d_in * beta)
    ln2_g = 1.0 + nrm(ks[18], (L, D_MODEL), 0.02)
    ln2_b = nrm(ks[19], (L, D_MODEL), 0.02)
    ffn2_w_gate = nrm(ks[20], (L, D_MODEL, D_FF), d_in)
    ffn2_w_up = nrm(ks[21], (L, D_MODEL, D_FF), d_in * beta)
    ffn2_w_down = nrm(ks[22], (L, D_FF, D_MODEL), D_FF ** -0.5 * beta)
    ln3_g = 1.0 + nrm(ks[23], (L, D_MODEL), 0.02)
    ln3_b = nrm(ks[24], (L, D_MODEL), 0.02)
    return {'x': x, 'ffn1_w_gate': ffn1_w_gate, 'ffn1_w_up': ffn1_w_up, 'ffn1_w_down': ffn1_w_down,
            'ln1_g': ln1_g, 'ln1_b': ln1_b, 'w_in': w_in, 'sg_ln_g': sg_ln_g, 'sg_ln_b': sg_ln_b,
            'sg_w_s': sg_w_s, 'sg_b_s': sg_b_s, 'rel_table': rel_table, 'w_proj_a': w_proj_a,
            'w_proj_b': w_proj_b, 'w_out': w_out, 'ln2_g': ln2_g, 'ln2_b': ln2_b,
            'ffn2_w_gate': ffn2_w_gate, 'ffn2_w_up': ffn2_w_up, 'ffn2_w_down': ffn2_w_down,
            'ln3_g': ln3_g, 'ln3_b': ln3_b}


def reference(x, ffn1_w_gate, ffn1_w_up, ffn1_w_down, ln1_g, ln1_b, w_in, sg_ln_g, sg_ln_b,
              sg_w_s, sg_b_s, rel_table, w_proj_a, w_proj_b, w_out, ln2_g, ln2_b,
              ffn2_w_gate, ffn2_w_up, ffn2_w_down, ln3_g, ln3_b):
    h = x
    for l in range(DEPTH):
        f1 = swiglu_ffn(h, ffn1_w_gate[l], ffn1_w_up[l], ffn1_w_down[l])
        h = layer_norm(DEEPNORM_ALPHA * h + MACARON_WEIGHT * f1, ln1_g[l], ln1_b[l])
        m = token_mixer(h, w_in[l], sg_ln_g[l], sg_ln_b[l], sg_w_s[l], sg_b_s[l], rel_table,
                        w_proj_a[l], w_proj_b[l], w_out[l])
        h = layer_norm(DEEPNORM_ALPHA * h + m, ln2_g[l], ln2_b[l])
        f2 = swiglu_ffn(h, ffn2_w_gate[l], ffn2_w_up[l], ffn2_w_down[l])
        h = layer_norm(DEEPNORM_ALPHA * h + MACARON_WEIGHT * f2, ln3_g[l], ln3_b[l])
    return h
```

```cpp
#include <hip/hip_runtime.h>
#include <hip/hip_cooperative_groups.h>
#include <cstdio>
#include <cstdint>
#define MK_N_LAUNCHES 16
namespace pg8 {
#define PG8_LAS __attribute__((address_space(3)))
typedef unsigned short bf16_t;
typedef short bf16x8 __attribute__((ext_vector_type(8)));
typedef float f32x4 __attribute__((ext_vector_type(4)));
typedef unsigned u32x4 __attribute__((ext_vector_type(4)));
constexpr int BM = 256, BK = 64, HALF = 128, HTB = HALF * BK * 2  , STAGE_BYTES = 8 * HTB, NXCD = 8, WGM = 8;

__host__ __device__ __forceinline__ int lds_byte(int r, int c) { const int st = (r >> 4) * 2 + (c >> 5), rr = r & 15, cc = c & 31, ob = rr * 64 + cc * 2; return st * 1024 + (ob ^ (((ob >> 9) & 1) << 5)); }
__host__ __device__ __forceinline__ void stage_rc(int b, int& R, int& C) { const int st = b / 1024, sb = b % 1024, swz = sb ^ (((sb >> 9) & 1) << 5); R = (st >> 1) * 16 + swz / 64; C = (st & 1) * 32 + (swz % 64) / 2; }
__host__ __device__ __forceinline__ int perm32(int rho) { const int n = rho >> 4, i = rho & 15; return 8 * (i >> 2) + 4 * n + (i & 3); }

struct Unit { int pm, pn; };
struct Gemm { const bf16_t* A; const bf16_t* Bt; int M, N, K; };

struct StaticOrder {
    int nM, nN, nwg, G, c;
    __host__ __device__ void init(int M, int N, int G_, int c_) { nM = M / BM; nN = N / BM; nwg = nM * nN; G = G_; c = c_; }
    __host__ __device__ bool next(int i, Unit& u) const {
        const long L = (long)i * G + c; if (L >= nwg) return false;
        int wgid = (int)L; { const int q = nwg / NXCD, r = nwg % NXCD, xcd = wgid % NXCD, off = wgid / NXCD; wgid = (xcd < r ? xcd * (q + 1) : r * (q + 1) + (xcd - r) * q) + off; }
        const int nig = WGM * nN, gid = wgid / nig, fm = gid * WGM, gsz = (nM - fm) < WGM ? (nM - fm) : WGM;
        u.pm = fm + ((wgid % nig) % gsz); u.pn = (wgid % nig) / gsz; return true;
    }
    __device__ __forceinline__ void a_ready(const Unit&) const {}
    __device__ __forceinline__ void done(const Unit&) const {}
};


typedef float f32x2 __attribute__((ext_vector_type(2)));
typedef __bf16 bf16x2_t __attribute__((ext_vector_type(2)));
__device__ __forceinline__ unsigned cvt_pk_bf16(float lo, float hi) { f32x2 v = {lo, hi}; bf16x2_t b = __builtin_convertvector(v, bf16x2_t); return __builtin_bit_cast(unsigned, b); }
__device__ __forceinline__ float bf_lo(unsigned w) { return __uint_as_float(w << 16); }
__device__ __forceinline__ float bf_hi(unsigned w) { return __uint_as_float(w & 0xffff0000u); }
__device__ __forceinline__ float sigmoid_f(float x) { return __builtin_amdgcn_rcpf(1.0f + __builtin_amdgcn_exp2f(-1.4426950408889634f * x)); }
__device__ __forceinline__ float silu_f(float x) { return x * sigmoid_f(x); }
__device__ __forceinline__ float gelu_tanh_f(float x) { const float t = x * (1.0f + 0.044715f * x * x); return x * __builtin_amdgcn_rcpf(1.0f + __builtin_amdgcn_exp2f(-2.3022081981f * t)); }

struct EpiSwiGLU {
    static constexpr bool PERM = true, AFTER_DRAIN = false;
    bf16_t* O; int ldc;
    __device__ __forceinline__ void operator()(const f32x4 (&acc)[2][2][4][2], const Unit& u, int wr, int wc, int fr, int fq) const {
        const int row0 = u.pm * BM + wr * 64 + fr, col0 = u.pn * HALF + wc * 32 + 8 * fq;
#pragma unroll
        for (int ai = 0; ai < 2; ++ai)
#pragma unroll
            for (int m = 0; m < 4; ++m) { bf16_t* rowp = O + (size_t)(row0 + ai * HALF + m * 16) * ldc + col0;
                const f32x4 g0 = acc[ai][0][m][0], g1 = acc[ai][0][m][1], u0 = acc[ai][1][m][0], u1 = acc[ai][1][m][1];
                u32x4 w; w.x = cvt_pk_bf16(silu_f(g0[0]) * u0[0], silu_f(g0[1]) * u0[1]); w.y = cvt_pk_bf16(silu_f(g0[2]) * u0[2], silu_f(g0[3]) * u0[3]);
                w.z = cvt_pk_bf16(silu_f(g1[0]) * u1[0], silu_f(g1[1]) * u1[1]); w.w = cvt_pk_bf16(silu_f(g1[2]) * u1[2], silu_f(g1[3]) * u1[3]);
                *(u32x4*)rowp = w; }
    }
};

struct EpiRes {
    static constexpr bool PERM = false, AFTER_DRAIN = false;
    const float* base; float* out; int ldc; float ra, rc;
    __device__ __forceinline__ void operator()(const f32x4 (&acc)[2][2][4][2], const Unit& u, int wr, int wc, int fr, int fq) const {
        const int row0 = u.pm * BM + wr * 64 + fr, col0 = u.pn * BM + wc * 32 + 4 * fq;
#pragma unroll
        for (int ai = 0; ai < 2; ++ai)
#pragma unroll
            for (int m = 0; m < 4; ++m) { const size_t off = (size_t)(row0 + ai * HALF + m * 16) * ldc + col0;
#pragma unroll
                for (int bj = 0; bj < 2; ++bj)
#pragma unroll
                    for (int n = 0; n < 2; ++n) { const f32x4 b = *(const f32x4*)(base + off + bj * HALF + n * 16); *(f32x4*)(out + off + bj * HALF + n * 16) = b * ra + acc[ai][bj][m][n] * rc; } }
    }
};

struct EpiInA {
    static constexpr bool PERM = true, AFTER_DRAIN = false;
    bf16_t* U; int ldu; bf16_t* V; int ldv; f32x2* stats;
    __device__ __forceinline__ void operator()(const f32x4 (&acc)[2][2][4][2], const Unit& u, int wr, int wc, int fr, int fq) const {
        const bool isv = u.pn >= 4;
        const int row0 = u.pm * BM + wr * 64 + fr, col0 = (u.pn & 3) * BM + wc * 32 + 8 * fq;
        bf16_t* base = isv ? V : U; const int ldc = isv ? ldv : ldu;
#pragma unroll
        for (int ai = 0; ai < 2; ++ai)
#pragma unroll
            for (int m = 0; m < 4; ++m) { const int row = row0 + ai * HALF + m * 16; bf16_t* rowp = base + (size_t)row * ldc + col0; float s = 0.f, q = 0.f;
#pragma unroll
                for (int bj = 0; bj < 2; ++bj) { f32x4 v0 = acc[ai][bj][m][0], v1 = acc[ai][bj][m][1];
#pragma unroll
                    for (int e = 0; e < 4; ++e) { v0[e] = gelu_tanh_f(v0[e]); v1[e] = gelu_tanh_f(v1[e]); s += v0[e] + v1[e]; q += v0[e] * v0[e] + v1[e] * v1[e]; }
                    u32x4 w; w.x = cvt_pk_bf16(v0[0], v0[1]); w.y = cvt_pk_bf16(v0[2], v0[3]); w.z = cvt_pk_bf16(v1[0], v1[1]); w.w = cvt_pk_bf16(v1[2], v1[3]);
                    *(u32x4*)(rowp + bj * HALF) = w; }
                if (isv) { s += __shfl_xor(s, 16); s += __shfl_xor(s, 32); q += __shfl_xor(q, 16); q += __shfl_xor(q, 32);
                    if (fq == 0) stats[(size_t)row * 16 + (u.pn & 3) * 4 + wc] = (f32x2){s, q}; } }
    }
};

struct EpiInB {
    static constexpr bool PERM = true, AFTER_DRAIN = false;
    bf16_t* Q; int ldq; bf16_t* K; bf16_t* VM; bf16_t* GA; bf16_t* GB; int ld;
    __device__ __forceinline__ void operator()(const f32x4 (&acc)[2][2][4][2], const Unit& u, int wr, int wc, int fr, int fq) const {
        const int t = u.pn >> 2;
        const int row0 = u.pm * BM + wr * 64 + fr, col0 = (u.pn & 3) * BM + wc * 32 + 8 * fq;
        bf16_t* base = t == 0 ? Q : t == 1 ? K : t == 2 ? VM : t == 3 ? GA : GB; const int ldc = t == 0 ? ldq : ld; const bool sg = t >= 3;
#pragma unroll
        for (int ai = 0; ai < 2; ++ai)
#pragma unroll
            for (int m = 0; m < 4; ++m) { bf16_t* rowp = base + (size_t)(row0 + ai * HALF + m * 16) * ldc + col0;
#pragma unroll
                for (int bj = 0; bj < 2; ++bj) { f32x4 v0 = acc[ai][bj][m][0], v1 = acc[ai][bj][m][1];
                    if (sg) {
#pragma unroll
                        for (int e = 0; e < 4; ++e) { v0[e] = sigmoid_f(v0[e]); v1[e] = sigmoid_f(v1[e]); } }
                    u32x4 w; w.x = cvt_pk_bf16(v0[0], v0[1]); w.y = cvt_pk_bf16(v0[2], v0[3]); w.z = cvt_pk_bf16(v1[0], v1[1]); w.w = cvt_pk_bf16(v1[2], v1[3]);
                    *(u32x4*)(rowp + bj * HALF) = w; } }
    }
};

struct EpiMerge {
    static constexpr bool PERM = true, AFTER_DRAIN = false;
    const bf16_t* GA; const bf16_t* GB; bf16_t* O; int ld;
    __device__ __forceinline__ void mid(f32x4 (&acc)[2][2][4][2], const Unit& u, int wr, int wc, int fr, int fq) const {
        int row0 = u.pm * BM + wr * 64 + fr, col0 = u.pn * BM + wc * 32 + 8 * fq;
        asm volatile("" : "+v"(row0), "+v"(col0));
#pragma unroll
        for (int ai = 0; ai < 2; ++ai)
#pragma unroll
            for (int m = 0; m < 4; ++m) { const size_t off = (size_t)(row0 + ai * HALF + m * 16) * ld + col0;
#pragma unroll
                for (int bj = 0; bj < 2; ++bj) { const u32x4 a = *(const u32x4*)(GA + off + bj * HALF), b = *(const u32x4*)(GB + off + bj * HALF);
                    f32x4 r0, r1;
                    r0[0] = bf_lo(a.x) * __builtin_amdgcn_rcpf(bf_lo(b.x)); r0[1] = bf_hi(a.x) * __builtin_amdgcn_rcpf(bf_hi(b.x)); r0[2] = bf_lo(a.y) * __builtin_amdgcn_rcpf(bf_lo(b.y)); r0[3] = bf_hi(a.y) * __builtin_amdgcn_rcpf(bf_hi(b.y));
                    r1[0] = bf_lo(a.z) * __builtin_amdgcn_rcpf(bf_lo(b.z)); r1[1] = bf_hi(a.z) * __builtin_amdgcn_rcpf(bf_hi(b.z)); r1[2] = bf_lo(a.w) * __builtin_amdgcn_rcpf(bf_lo(b.w)); r1[3] = bf_hi(a.w) * __builtin_amdgcn_rcpf(bf_hi(b.w));
                    acc[ai][bj][m][0] *= r0; acc[ai][bj][m][1] *= r1; }
                asm volatile("" ::: "memory"); }
    }
    __device__ __forceinline__ void operator()(const f32x4 (&acc)[2][2][4][2], const Unit& u, int wr, int wc, int fr, int fq) const {
        const int row0 = u.pm * BM + wr * 64 + fr, col0 = u.pn * BM + wc * 32 + 8 * fq;
#pragma unroll
        for (int ai = 0; ai < 2; ++ai)
#pragma unroll
            for (int m = 0; m < 4; ++m) { const size_t off = (size_t)(row0 + ai * HALF + m * 16) * ld + col0;
#pragma unroll
                for (int bj = 0; bj < 2; ++bj) { const u32x4 b = *(const u32x4*)(GB + off + bj * HALF); const f32x4 v0 = acc[ai][bj][m][0], v1 = acc[ai][bj][m][1];
                    u32x4 w; w.x = cvt_pk_bf16(v0[0] * bf_lo(b.x), v0[1] * bf_hi(b.x)); w.y = cvt_pk_bf16(v0[2] * bf_lo(b.y), v0[3] * bf_hi(b.y));
                    w.z = cvt_pk_bf16(v1[0] * bf_lo(b.z), v1[1] * bf_hi(b.z)); w.w = cvt_pk_bf16(v1[2] * bf_lo(b.w), v1[3] * bf_hi(b.w));
                    *(u32x4*)(O + off + bj * HALF) = w; } }
    }
};
template <class Epi, class Sched, bool ALIGN_EPI = false, bool SP2 = false, int HOOK_T = 0>
__device__ __forceinline__ void gemm_phase(PG8_LAS unsigned char* lds, const Gemm g, const Sched& S, const Epi& E) {
    const int tid = threadIdx.x, wid = __builtin_amdgcn_readfirstlane(tid >> 6), lane = tid & 63, wr = wid >> 2, wc = wid & 3, fr = lane & 15, fq = lane >> 4;
    const int K = g.K, nt = K / BK;
    unsigned voffA[2], voffB[2];
#pragma unroll
    for (int i = 0; i < 2; ++i) { int R, C; stage_rc(tid * 16 + i * 8192, R, C); const int Rb = Epi::PERM ? ((R & ~31) + perm32(R & 31)) : R;
        voffA[i] = (unsigned)(R * K + C) * 2u; voffB[i] = (unsigned)(Rb * K + C) * 2u; }
    const size_t kstep = (size_t)(BK * 2);
    const size_t hstep = (size_t)HALF * K * 2;
    const size_t tstep = 2 * hstep;
    const unsigned ldsw = (unsigned)wid * 1024u;
    const int aoff = lds_byte(wr * 64 + fr, fq * 8), boff = lds_byte(wc * 32 + fr, fq * 8);
#define PG8_SA(b, h) (((b) * 2 + (h)) * HTB)
#define PG8_SB(b, h) ((4 + (b) * 2 + (h)) * HTB)
#define PG8_STAGE(bufoff, gbase, voff) do { _Pragma("unroll") for (int _i = 0; _i < 2; ++_i) \
        __builtin_amdgcn_global_load_lds((const unsigned*)((const char*)(gbase) + (voff)[_i]), (PG8_LAS unsigned*)(lds + (bufoff) + ldsw + _i * 8192), 16, 0, 0); } while (0)
#define PG8_LDA(dst, b, h) do { _Pragma("unroll") for (int m = 0; m < 4; ++m) _Pragma("unroll") for (int k = 0; k < 2; ++k) dst[m][k] = *(const PG8_LAS bf16x8*)(lds + PG8_SA(b, h) + aoff + m * 2048 + k * 1024); } while (0)
#define PG8_LDB(dst, b, h) do { _Pragma("unroll") for (int n = 0; n < 2; ++n) _Pragma("unroll") for (int k = 0; k < 2; ++k) dst[n][k] = *(const PG8_LAS bf16x8*)(lds + PG8_SB(b, h) + boff + n * 2048 + k * 1024); } while (0)
#define PG8_MMA(ai, bj, At, Bt) do { __builtin_amdgcn_s_setprio(1); _Pragma("unroll") for (int m = 0; m < 4; ++m) _Pragma("unroll") for (int n = 0; n < 2; ++n) _Pragma("unroll") for (int k = 0; k < 2; ++k) \
        acc[ai][bj][m][n] = __builtin_amdgcn_mfma_f32_16x16x32_bf16(Bt[n][k], At[m][k], acc[ai][bj][m][n], 0, 0, 0); __builtin_amdgcn_s_setprio(0); } while (0)
#define PG8_WAIT_V(n) asm volatile("s_waitcnt vmcnt(" #n ")" ::: "memory")
#define PG8_WAIT_L(n) asm volatile("s_waitcnt lgkmcnt(" #n ")" ::: "memory")
#define PG8_BAR __builtin_amdgcn_s_barrier()
#define PG8_SCHED __builtin_amdgcn_sched_barrier(0)
    Unit cur, nxt; int ui = 0;
    if (!S.next(0, cur)) return;
    f32x4 acc[2][2][4][2];
#pragma unroll
    for (int a = 0; a < 2; ++a)
#pragma unroll
        for (int b = 0; b < 2; ++b)
#pragma unroll
            for (int m = 0; m < 4; ++m)
#pragma unroll
                for (int n = 0; n < 2; ++n) acc[a][b][m][n] = (f32x4){0.f, 0.f, 0.f, 0.f};
    bf16x8 At[4][2], B0[2][2], B1[2][2];
    const char* cA = (const char*)g.A + (size_t)cur.pm * tstep; const char* cB = (const char*)g.Bt + (size_t)cur.pn * tstep;
    S.a_ready(cur);
    if constexpr (SP2) {
        PG8_STAGE(PG8_SB(0, 0), cB, voffB); PG8_STAGE(PG8_SB(0, 1), cB + hstep, voffB); PG8_STAGE(PG8_SA(0, 0), cA, voffA); PG8_STAGE(PG8_SA(0, 1), cA + hstep, voffA);
        if (wr == 1) PG8_BAR;
        PG8_WAIT_V(2); PG8_BAR;
        PG8_STAGE(PG8_SB(1, 0), cB + kstep, voffB); PG8_STAGE(PG8_SA(1, 0), cA + kstep, voffA); PG8_STAGE(PG8_SB(1, 1), cB + hstep + kstep, voffB);
        PG8_WAIT_V(6); PG8_BAR;
    } else {
        PG8_STAGE(PG8_SB(0, 0), cB, voffB); PG8_STAGE(PG8_SA(0, 0), cA, voffA); PG8_STAGE(PG8_SB(0, 1), cB + hstep, voffB); PG8_STAGE(PG8_SA(0, 1), cA + hstep, voffA);
        if (wr == 1) PG8_BAR;
        PG8_WAIT_V(4); PG8_BAR;
        PG8_STAGE(PG8_SB(1, 0), cB + kstep, voffB); PG8_STAGE(PG8_SA(1, 0), cA + kstep, voffA); PG8_STAGE(PG8_SB(1, 1), cB + hstep + kstep, voffB);
        PG8_WAIT_V(6); PG8_BAR;
    }
    for (;;) {
        const bool has_next = S.next(ui + 1, nxt);
        const char* nA = has_next ? (const char*)g.A + (size_t)nxt.pm * tstep : cA; const char* nB = has_next ? (const char*)g.Bt + (size_t)nxt.pn * tstep : cB;
        for (int t = 0; t < nt; t += 2) {
            if constexpr (HOOK_T > 0) { if (t == HOOK_T) E.mid(acc, cur, wr, wc, fr, fq); }
            const bool last = (t == nt - 2);
            const char* a1 = cA + (size_t)(t + 1) * kstep;
            const char* a2 = last ? nA : cA + (size_t)(t + 2) * kstep; const char* b2 = last ? nB : cB + (size_t)(t + 2) * kstep;
            const char* a3 = a2 + kstep; const char* b3 = b2 + kstep;
            if (last && has_next) S.a_ready(nxt);
            if constexpr (SP2) {
            PG8_LDB(B0, 0, 0); PG8_LDB(B1, 0, 1); PG8_SCHED; PG8_LDA(At, 0, 0); PG8_STAGE(PG8_SA(1, 1), a1 + hstep, voffA);
            PG8_WAIT_V(8); PG8_WAIT_L(0); PG8_BAR; PG8_MMA(0, 0, At, B0); PG8_MMA(0, 1, At, B1); PG8_BAR; PG8_SCHED;
            PG8_LDA(At, 0, 1); PG8_STAGE(PG8_SB(0, 0), b2, voffB); PG8_STAGE(PG8_SB(0, 1), b2 + hstep, voffB); PG8_STAGE(PG8_SA(0, 0), a2, voffA);
            PG8_WAIT_V(8); PG8_WAIT_L(0); PG8_BAR; PG8_MMA(1, 0, At, B0); PG8_MMA(1, 1, At, B1); PG8_BAR; PG8_SCHED;
            PG8_LDB(B0, 1, 0); PG8_LDB(B1, 1, 1); PG8_SCHED; PG8_LDA(At, 1, 0); PG8_STAGE(PG8_SA(0, 1), a2 + hstep, voffA);
            PG8_WAIT_V(8); PG8_WAIT_L(0); PG8_BAR; PG8_MMA(0, 0, At, B0); PG8_MMA(0, 1, At, B1); PG8_BAR; PG8_SCHED;
            PG8_LDA(At, 1, 1); PG8_STAGE(PG8_SB(1, 0), b3, voffB); PG8_STAGE(PG8_SB(1, 1), b3 + hstep, voffB); PG8_STAGE(PG8_SA(1, 0), a3, voffA);
            PG8_WAIT_V(8); PG8_WAIT_L(0); PG8_BAR; PG8_MMA(1, 0, At, B0); PG8_MMA(1, 1, At, B1); PG8_BAR; PG8_SCHED;
            } else {
            PG8_LDB(B0, 0, 0); PG8_SCHED; PG8_LDA(At, 0, 0); PG8_STAGE(PG8_SA(1, 1), a1 + hstep, voffA);
            PG8_WAIT_L(8); PG8_BAR; PG8_WAIT_L(0); PG8_MMA(0, 0, At, B0); PG8_BAR; PG8_SCHED;
            PG8_LDB(B1, 0, 1); PG8_STAGE(PG8_SB(0, 0), b2, voffB);
            PG8_BAR; PG8_WAIT_L(0); PG8_MMA(0, 1, At, B1); PG8_BAR;
            PG8_LDA(At, 0, 1); PG8_STAGE(PG8_SA(0, 0), a2, voffA);
            PG8_BAR; PG8_WAIT_L(0); PG8_MMA(1, 0, At, B0); PG8_BAR; PG8_SCHED;
            PG8_STAGE(PG8_SB(0, 1), b2 + hstep, voffB);
            PG8_WAIT_V(6); PG8_BAR; PG8_MMA(1, 1, At, B1); PG8_BAR;
            PG8_LDB(B0, 1, 0); PG8_SCHED; PG8_LDA(At, 1, 0); PG8_STAGE(PG8_SA(0, 1), a2 + hstep, voffA);
            PG8_WAIT_L(8); PG8_BAR; PG8_WAIT_L(0); PG8_MMA(0, 0, At, B0); PG8_BAR; PG8_SCHED;
            PG8_LDB(B1, 1, 1); PG8_STAGE(PG8_SB(1, 0), b3, voffB);
            PG8_BAR; PG8_WAIT_L(0); PG8_MMA(0, 1, At, B1); PG8_BAR;
            PG8_LDA(At, 1, 1); PG8_STAGE(PG8_SA(1, 0), a3, voffA);
            PG8_BAR; PG8_WAIT_L(0); PG8_MMA(1, 0, At, B0); PG8_BAR; PG8_SCHED;
            PG8_STAGE(PG8_SB(1, 1), b3 + hstep, voffB);
            PG8_WAIT_V(6); PG8_BAR; PG8_MMA(1, 1, At, B1); PG8_BAR;
            }
        }
        if constexpr (ALIGN_EPI) { if (wr == 0) PG8_BAR; }
        if constexpr (!Epi::AFTER_DRAIN) { E(acc, cur, wr, wc, fr, fq); S.done(cur); }
        if (!has_next) break;
#pragma unroll
        for (int a = 0; a < 2; ++a)
#pragma unroll
            for (int b = 0; b < 2; ++b)
#pragma unroll
                for (int m = 0; m < 4; ++m)
#pragma unroll
                    for (int n = 0; n < 2; ++n) acc[a][b][m][n] = (f32x4){0.f, 0.f, 0.f, 0.f};
        cur = nxt; cA = nA; cB = nB; ++ui;
        if constexpr (ALIGN_EPI) { if (wr == 1) PG8_BAR; }
    }
    PG8_WAIT_V(0);
    if constexpr (!ALIGN_EPI) { if (wr == 0) PG8_BAR; }
    PG8_BAR;
    if constexpr (Epi::AFTER_DRAIN) { E.fused(acc, cur, wr, wc, fr, fq, lds, wid, lane); S.done(cur); }
#undef PG8_SA
#undef PG8_SB
#undef PG8_STAGE
#undef PG8_LDA
#undef PG8_LDB
#undef PG8_MMA
#undef PG8_WAIT_V
#undef PG8_WAIT_L
#undef PG8_BAR
#undef PG8_SCHED
}
}

namespace moba {
typedef unsigned short bf16_t;
typedef short bf16x8 __attribute__((ext_vector_type(8)));
typedef short s16x4 __attribute__((ext_vector_type(4)));
typedef float f32x16 __attribute__((ext_vector_type(16)));
typedef float f32x4 __attribute__((ext_vector_type(4)));
typedef float f32x2 __attribute__((ext_vector_type(2)));
typedef __bf16 bf16x2_t __attribute__((ext_vector_type(2)));
typedef unsigned u32x4 __attribute__((ext_vector_type(4)));
constexpr int D = 128, NW = 8, QBLK = 32, KVBLK = 64, QB = NW * QBLK;
constexpr int QP = 2048, KP = 1024, VP = 1024;
constexpr int SHM_V = KVBLK * D * 2, SHM_K = KVBLK * D * 2;
constexpr int LDS_WS = 2 * SHM_V + 2 * SHM_K;
constexpr int LDS_LUT = LDS_WS + NW * 64 * 4;
constexpr int LDS_BYTES = LDS_LUT + 8 * 128 * 4;
constexpr float SCALE = 0.08838834764831845f;
constexpr float THR = 8.f;

#define KSWZ(row, colB) ((row) * 256 + ((colB) ^ (((row) & 7) << 4)))
#define SBAR() __builtin_amdgcn_sched_barrier(0)
__device__ __forceinline__ int v_st(int k, int c) { const int kk = (k & ~0xC) | ((k & 4) << 1) | ((k & 8) >> 1); return ((kk >> 3) * 4 + (c >> 5)) * 512 + ((kk & 7) * 32 + (c & 31)) * 2; }
__device__ __forceinline__ int v_rd_base(int lane) { return ((lane & 3) << 3) | (((lane >> 2) & 3) << 6) | (((lane >> 4) & 1) << 5) | (((lane >> 5) & 1) << 8); }
constexpr int v_rd_off(int d0, int ks, int half) { return d0 * 512 + ks * 4096 + half * 2048; }
__device__ __forceinline__ int crow(int r, int hi) { return (r & 3) + 8 * (r >> 2) + 4 * hi; }
__device__ __forceinline__ unsigned cvtpk(float lo, float hi) { f32x2 v = {lo, hi}; bf16x2_t b = __builtin_convertvector(v, bf16x2_t); return __builtin_bit_cast(unsigned, b); }
__device__ __forceinline__ bf16x8 load8(const bf16_t* p) { return *reinterpret_cast<const bf16x8*>(p); }

__device__ __forceinline__ void sel_tile(f32x16& p0, f32x16& p1, bool keep) {
    const float NEG = -__builtin_inff();
#pragma unroll
    for (int r = 0; r < 16; ++r) { p0[r] = keep ? p0[r] : NEG; p1[r] = keep ? p1[r] : NEG; }
}
__device__ __forceinline__ void bias_tile(f32x16& p0, f32x16& p1, int dq, const float* lut) {
    const float NEG = -__builtin_inff();
#pragma unroll
    for (int r = 0; r < 16; ++r) {
        const int c = (r & 3) + 8 * (r >> 2);
        const int d0 = dq - c, d1 = dq - c - 32;
        const unsigned i0 = (unsigned)d0 > 127u ? 127u : (unsigned)d0, i1 = (unsigned)d1 > 127u ? 127u : (unsigned)d1;
        const float b0 = lut[i0], b1 = lut[i1];
        p0[r] = d0 < 0 ? NEG : p0[r] + b0;
        p1[r] = d1 < 0 ? NEG : p1[r] + b1;
    }
}
__device__ __forceinline__ void partialSM(f32x16& p0, f32x16& p1, float& m_reg, float& mn, float& alpha) {
    float pmax = p0[0];
#pragma unroll
    for (int r = 1; r < 16; ++r) pmax = fmaxf(pmax, p0[r]);
#pragma unroll
    for (int r = 0; r < 16; ++r) pmax = fmaxf(pmax, p1[r]);
    { auto rr = __builtin_amdgcn_permlane32_swap(__float_as_uint(pmax), __float_as_uint(pmax), false, false);
      pmax = fmaxf(__uint_as_float(rr[0]), __uint_as_float(rr[1])); }
    constexpr float C2 = 1.4426950408889634f * SCALE;
    if (__builtin_expect(__all((pmax - m_reg) * SCALE <= THR), 1)) { mn = m_reg; alpha = 1.f; }
    else { mn = fmaxf(m_reg, pmax); alpha = __builtin_amdgcn_exp2f((m_reg - mn) * C2); m_reg = mn; }
    const float mnL = -mn * C2;
#pragma unroll
    for (int r = 0; r < 16; ++r) p0[r] = fmaf(p0[r], C2, mnL);
#pragma unroll
    for (int r = 0; r < 16; ++r) p1[r] = fmaf(p1[r], C2, mnL);
#pragma unroll
    for (int r = 0; r < 16; ++r) p0[r] = __builtin_amdgcn_exp2f(p0[r]);
}
__device__ __forceinline__ void finishSM(f32x16& p0, f32x16& p1, float alpha, float& l_reg, bf16x8& pa0, bf16x8& pa1, bf16x8& pa2, bf16x8& pa3) {
#pragma unroll
    for (int r = 0; r < 16; ++r) p1[r] = __builtin_amdgcn_exp2f(p1[r]);
    float ps = 0;
#pragma unroll
    for (int r = 0; r < 16; ++r) ps += p0[r];
#pragma unroll
    for (int r = 0; r < 16; ++r) ps += p1[r];
    { auto rr = __builtin_amdgcn_permlane32_swap(__float_as_uint(ps), __float_as_uint(ps), false, false);
      ps = __uint_as_float(rr[0]) + __uint_as_float(rr[1]); }
    l_reg = l_reg * alpha + ps;
#define PK4(P, B_, OUT) do { unsigned a0 = cvtpk(P[B_+0], P[B_+1]), a1 = cvtpk(P[B_+2], P[B_+3]);                          \
        unsigned b0 = cvtpk(P[B_+4], P[B_+5]), b1 = cvtpk(P[B_+6], P[B_+7]);                                             \
        auto r0 = __builtin_amdgcn_permlane32_swap(a0, b0, false, false); auto r1 = __builtin_amdgcn_permlane32_swap(a1, b1, false, false); \
        u32x4 w = {r0[0], r1[0], r0[1], r1[1]}; OUT = *reinterpret_cast<bf16x8*>(&w); } while (0)
    PK4(p0, 0, pa0); PK4(p0, 8, pa1); PK4(p1, 0, pa2); PK4(p1, 8, pa3);
#undef PK4
}
template <int KB>
__device__ __forceinline__ void qkt(f32x16& p0, f32x16& p1, const char* K_lds, int r32, int hi, const bf16x8* qr) {
    p0 = f32x16{}; p1 = f32x16{};
    const char* kb[4];
#pragma unroll
    for (int dd = 0; dd < 4; ++dd) kb[dd] = K_lds + KB * SHM_K + KSWZ(r32, (dd * 16 + hi * 8) * 2);
#pragma unroll
    for (int d0 = 0; d0 < 8; ++d0) { const char* a = kb[d0 & 3] + (d0 >> 2) * 128;
        bf16x8 b0 = *reinterpret_cast<const bf16x8*>(a);
        bf16x8 b1 = *reinterpret_cast<const bf16x8*>(a + 32 * 256);
        p0 = __builtin_amdgcn_mfma_f32_32x32x16_bf16(b0, qr[d0], p0, 0, 0, 0);
        p1 = __builtin_amdgcn_mfma_f32_32x32x16_bf16(b1, qr[d0], p1, 0, 0, 0); }
}
#define MOBA_TRRD(dst, base, off) asm volatile("ds_read_b64_tr_b16 %0, %1 offset:%2" : "=&v"(dst) : "v"(base), "i"(off) : "memory")
#define MOBA_PV_D0(o_, vb0_, TB, d0) do { moba::s16x4 l0, l1, l2, l3, h0, h1, h2, h3; constexpr int b_ = (TB) + moba::v_rd_off(d0, 0, 0);   \
        MOBA_TRRD(l0, vb0_, b_); MOBA_TRRD(h0, vb0_, b_ + 2048); MOBA_TRRD(l1, vb0_, b_ + 4096); MOBA_TRRD(h1, vb0_, b_ + 6144); MOBA_TRRD(l2, vb0_, b_ + 8192); MOBA_TRRD(h2, vb0_, b_ + 10240); MOBA_TRRD(l3, vb0_, b_ + 12288); MOBA_TRRD(h3, vb0_, b_ + 14336); \
        asm volatile("s_waitcnt lgkmcnt(0)" ::: "memory"); __builtin_amdgcn_sched_barrier(0);                                             \
        o_ = __builtin_amdgcn_mfma_f32_32x32x16_bf16(pa0, (moba::bf16x8){l0[0], l0[1], l0[2], l0[3], h0[0], h0[1], h0[2], h0[3]}, o_, 0, 0, 0);   \
        o_ = __builtin_amdgcn_mfma_f32_32x32x16_bf16(pa1, (moba::bf16x8){l1[0], l1[1], l1[2], l1[3], h1[0], h1[1], h1[2], h1[3]}, o_, 0, 0, 0);   \
        o_ = __builtin_amdgcn_mfma_f32_32x32x16_bf16(pa2, (moba::bf16x8){l2[0], l2[1], l2[2], l2[3], h2[0], h2[1], h2[2], h2[3]}, o_, 0, 0, 0);   \
        o_ = __builtin_amdgcn_mfma_f32_32x32x16_bf16(pa3, (moba::bf16x8){l3[0], l3[1], l3[2], l3[3], h3[0], h3[1], h3[2], h3[3]}, o_, 0, 0, 0); } while (0)
template <int VB>
__device__ __forceinline__ void pv_tile(f32x16* o, int vb0, bf16x8 pa0, bf16x8 pa1, bf16x8 pa2, bf16x8 pa3) {
    MOBA_PV_D0(o[0], vb0, VB * SHM_V, 0); MOBA_PV_D0(o[1], vb0, VB * SHM_V, 1); MOBA_PV_D0(o[2], vb0, VB * SHM_V, 2); MOBA_PV_D0(o[3], vb0, VB * SHM_V, 3);
}

struct BlockRef { const bf16_t* Q; const bf16_t* K; const bf16_t* V; bf16_t* O; const unsigned* sel; int P0; int h; };
struct Seam { bf16x8 qr[8]; bf16x8 st_v0, st_v1, st_k0, st_k1; };
#define MROW(p, pitch, k0, rr) ((p) + (size_t)((k0) + (rr)) * (pitch) + kvo)
#define VMW() asm volatile("s_waitcnt vmcnt(0)" ::: "memory")
#define VMWN(n) asm volatile("s_waitcnt vmcnt(%0)" :: "i"(n) : "memory")
#define SLOAD_H(Kp, Vp, k0) do { S.st_v0 = load8(MROW(Vp, VP, k0, 0)); S.st_v1 = load8(MROW(Vp, VP, k0, 32));              \
                         S.st_k0 = load8(MROW(Kp, KP, k0, 0)); S.st_k1 = load8(MROW(Kp, KP, k0, 32)); } while (0)
#define SWRITE_HK(bf) do { *(bf16x8*)(K_lds + (bf) * SHM_K + kws) = S.st_k0; *(bf16x8*)(K_lds + (bf) * SHM_K + kws + 32 * 256) = S.st_k1; } while (0)
#define SWRITE_HV(bf) do { *(bf16x8*)(V_lds + (bf) * SHM_V + vst0) = S.st_v0; *(bf16x8*)(V_lds + (bf) * SHM_V + vst1) = S.st_v1; } while (0)
#define SWRITE_H(bf) do { SWRITE_HV(bf); SWRITE_HK(bf); } while (0)
__device__ __forceinline__ void moba_prime(const BlockRef& cur, char* lds, Seam& S) {
    const int tid = threadIdx.x, wid = __builtin_amdgcn_readfirstlane(tid >> 6), lane = tid & 63, r32 = lane & 31, hi = lane >> 5;
    const int sr = tid >> 4, sc = (tid & 15) * 8, kws = KSWZ(sr, sc * 2); char* K_lds = lds + 2 * SHM_V;
    const unsigned kvo = (unsigned)(sr * KP + sc), qo = (unsigned)(r32 * QP + hi * 8);
    static_assert(KP == VP, "one staging offset for K and V");
#pragma unroll
    for (int d0 = 0; d0 < 8; ++d0) S.qr[d0] = load8(cur.Q + (size_t)(wid * QBLK) * QP + qo + d0 * 16);
    SLOAD_H(cur.K, cur.V, 0); VMW(); SWRITE_HK(0);
    __syncthreads();
}
__device__ __forceinline__ void moba_block(const BlockRef& cur, const BlockRef& nxt, char* lds, Seam& S) {
    const int tid = threadIdx.x, wid = __builtin_amdgcn_readfirstlane(tid >> 6), lane = tid & 63, r32 = lane & 31, hi = lane >> 5;
    const int NT = (cur.P0 + QB) / KVBLK;
    const int qlo = cur.P0 + wid * QBLK, qm = qlo + r32 - 4 * hi;
    char* V_lds = lds; char* K_lds = lds + 2 * SHM_V;
    float* ws = (float*)(lds + LDS_WS) + wid * 64; float* li_l = ws, * al_l = ws + 32;
    const float* lut = (const float*)(lds + LDS_LUT) + cur.h * 128;
    const unsigned selm = cur.sel[wid * QBLK + r32];
    float m_reg = -1e30f, l_reg = 0; f32x16 o[4] = {};
    const int sr = tid >> 4, sc = (tid & 15) * 8, vst0 = v_st(sr, sc), vst1 = v_st(32 + sr, sc), kws = KSWZ(sr, sc * 2);
    const unsigned kvo = (unsigned)(sr * KP + sc);
    const int vb0 = (int)(uintptr_t)V_lds + v_rd_base(lane);
    const bf16_t* Kh = cur.K; const bf16_t* Vh = cur.V;
#define RESC(a) do { if (__any((a) < 1.f)) { if (hi == 0) al_l[r32] = (a); asm volatile("s_waitcnt lgkmcnt(0)" ::: "memory");              \
                     for (int d_ = 0; d_ < 4; ++d_) for (int r = 0; r < 16; ++r) o[d_][r] *= al_l[crow(r, hi)]; } } while (0)
#define KBASE(t) ((t) * KVBLK)
#define MASKT(P0_, P1_, t) do { const int kb_ = KBASE(t);                                                                               \
        if (kb_ < cur.P0) sel_tile(P0_, P1_, ((selm >> (kb_ >> 8)) & 1u) != 0u);                                                          \
        if (kb_ + KVBLK - 1 + 113 > qlo) bias_tile(P0_, P1_, qm - kb_, lut); } while (0)
    constexpr int NQL = 8;
#define SEAM_K0() do { VMWN(NQL); SWRITE_HK(0); SBAR(); } while (0)
    f32x16 pA0, pA1, pB0, pB1; float mnA, mnB, alA, alB; bf16x8 pa0, pa1, pa2, pa3;
    SWRITE_HV(0); SBAR();
    if (NT > 1) SLOAD_H(Kh, Vh, KBASE(1));
    SBAR(); qkt<0>(pA0, pA1, K_lds, r32, hi, S.qr);
    MASKT(pA0, pA1, 0); partialSM(pA0, pA1, m_reg, mnA, alA);
    if (NT > 1) { VMW(); SWRITE_H(1); }
    __syncthreads();
#define HALF_STEP(PX0, PX1, mnX, alX, PY0, PY1, alY, t, KB, VB, SB) do {                                                      \
        SBAR(); qkt<KB>(PX0, PX1, K_lds, r32, hi, S.qr);                                                                      \
        finishSM(PY0, PY1, alY, l_reg, pa0, pa1, pa2, pa3); SBAR();                                                           \
        if ((t) + 1 < NT) { SLOAD_H(Kh, Vh, KBASE((t) + 1)); SBAR(); }                                                        \
        pv_tile<VB>(o, vb0, pa0, pa1, pa2, pa3); MASKT(PX0, PX1, (t)); partialSM(PX0, PX1, m_reg, mnX, alX);                  \
        __syncthreads();                                                                                                      \
        if ((t) + 1 < NT) { VMW(); SWRITE_H(SB); }                                                                            \
        RESC(alX); __syncthreads(); } while (0)
    for (int t = 1; t + 1 < NT; t += 2) {
        HALF_STEP(pB0, pB1, mnB, alB, pA0, pA1, alA, t, 1, 0, 0);
        HALF_STEP(pA0, pA1, mnA, alA, pB0, pB1, alB, t + 1, 0, 1, 1);
    }
    const bool even = (NT & 1) == 0;
    if (even) { SBAR(); qkt<1>(pB0, pB1, K_lds, r32, hi, S.qr); SBAR(); }
    SLOAD_H(nxt.K, nxt.V, 0); SBAR();
    { unsigned qo = (unsigned)(r32 * QP + hi * 8); asm volatile("" : "+v"(qo));
#pragma unroll
      for (int d0 = 0; d0 < 8; ++d0) S.qr[d0] = load8(nxt.Q + (size_t)(wid * QBLK) * QP + qo + d0 * 16); }
    SBAR();
    finishSM(pA0, pA1, alA, l_reg, pa0, pa1, pa2, pa3); SBAR();
    pv_tile<0>(o, vb0, pa0, pa1, pa2, pa3);
    if (even) { MASKT(pB0, pB1, NT - 1); partialSM(pB0, pB1, m_reg, mnB, alB); __syncthreads(); RESC(alB);
        finishSM(pB0, pB1, alB, l_reg, pa0, pa1, pa2, pa3); SBAR(); pv_tile<1>(o, vb0, pa0, pa1, pa2, pa3); }
    SBAR(); SEAM_K0();
    if (hi == 0) li_l[r32] = l_reg; asm volatile("s_waitcnt lgkmcnt(0)" ::: "memory");
    float rli[16];
#pragma unroll
    for (int r = 0; r < 16; ++r) rli[r] = __builtin_amdgcn_rcpf(li_l[crow(r, hi)]);
    bf16_t* Ow = cur.O + (size_t)(wid * QBLK) * QP;
    unsigned oo = (unsigned)(4 * hi * QP + r32); asm volatile("" : "+v"(oo));
#pragma unroll
    for (int r = 0; r < 16; ++r) { const int orow0 = (r & 3) + 8 * (r >> 2);
#pragma unroll
        for (int d0 = 0; d0 < 4; ++d0) { const float v = o[d0][r] * rli[r];
            const float vn = __shfl_xor(v, 1);
            if ((r32 & 1) == 0) *(unsigned*)(Ow + (size_t)orow0 * QP + d0 * 32 + oo) = cvtpk(v, vn); } }
    __syncthreads();
#undef RESC
#undef KBASE
#undef MASKT
#undef SEAM_K0
#undef HALF_STEP
}
#undef MROW
#undef VMW
#undef VMWN
#undef SLOAD_H
#undef SWRITE_HK
#undef SWRITE_HV
#undef SWRITE_H
#undef SBAR
#undef KSWZ
}

#ifndef MK_N_LAUNCHES
#define MK_N_LAUNCHES 1
#endif
constexpr int NWAVES = 8, NTHREADS = 512;
constexpr int NPH = 16;
constexpr int BATCH = 8, SEQ = 4096, DM = 1024, DFF = 2816, NHEAD = 8, HD = 128, NBLK = 16, MBLK = 256;
constexpr int M = BATCH * SEQ;
constexpr int NIN_A = 2048, NIN_B = 5120, NIN = NIN_A + NIN_B;
constexpr float LN_EPS = 1e-5f;
constexpr float ALPHA = 1.189207115002721f;
constexpr size_t MiB = 1u << 20;
constexpr size_t WS_CTL = 0, CTL_ZERO_BYTES = 64 * 1024;
constexpr size_t WS_W1A = 1 * MiB;
constexpr size_t WS_W1D = 12 * MiB;
constexpr size_t WS_W2A = WS_W1D + 5632 * 1024;
constexpr size_t WS_W2D = WS_W2A + 11 * MiB;
constexpr size_t WS_WIN = 34 * MiB;
constexpr size_t WS_WPAB = 48 * MiB;
constexpr size_t WS_WOUT = 52 * MiB;
constexpr size_t WS_WST = 54 * MiB;
constexpr size_t WS_KMEAN = 54 * MiB + 512 * 1024;
constexpr size_t WS_SEL = 55 * MiB;
constexpr size_t WS_SLOT0 = 56 * MiB, SLOT = 64 * MiB;
constexpr size_t WS_STATS = 504 * MiB;
constexpr size_t WS_END = 512 * MiB;
#define WS_S(i) (WS_SLOT0 + (size_t)(i) * SLOT)
static_assert(WS_W2D + 5632 * 1024 <= WS_WIN && WS_S(7) == WS_STATS && WS_STATS + (size_t)M * 16 * 8 <= WS_END, "d_ws map");
constexpr size_t WS_XB = WS_S(0);
constexpr size_t WS_HID1 = WS_S(1);
constexpr size_t WS_H1B = WS_S(0);
constexpr size_t WS_YAB = WS_S(1);
constexpr size_t WS_VB = WS_S(3);
constexpr size_t WS_KB = WS_S(4);
constexpr size_t WS_VMB = WS_S(5);
constexpr size_t WS_GA = WS_S(6);
constexpr size_t WS_GB = WS_S(3);
constexpr size_t WS_MRG = WS_S(4);
constexpr size_t WS_H2B = WS_S(5);
constexpr size_t WS_HID2 = WS_S(0);
constexpr int RING_OFF = 0, RING_BYTES = 131072;
constexpr int LDSCTL_OFF = RING_BYTES, MISC_OFF = LDSCTL_OFF + 320;
constexpr int LDS_BYTES = 147456;
static_assert(moba::LDS_BYTES <= RING_BYTES, "attention LDS");
constexpr int CW_BAR = 4096;
static_assert((CW_BAR + 3456) * 4 <= (int)CTL_ZERO_BYTES, "CTL");

#define GAS __attribute__((address_space(1)))
#define LAS __attribute__((address_space(3)))
typedef unsigned short bf16;
typedef unsigned v4u __attribute__((ext_vector_type(4)));
typedef unsigned v2u __attribute__((ext_vector_type(2)));
typedef float f32x4 __attribute__((ext_vector_type(4)));
typedef float f32x2 __attribute__((ext_vector_type(2)));
typedef float f32x16 __attribute__((ext_vector_type(16)));
typedef short bf16x8 __attribute__((ext_vector_type(8)));
typedef GAS unsigned gu32;
#define RLX_AGENT __ATOMIC_RELAXED, __HIP_MEMORY_SCOPE_AGENT
#define LDS_WAIT() asm volatile("s_waitcnt lgkmcnt(0)" ::: "memory")
#define VM_WAIT() asm volatile("s_waitcnt vmcnt(0)" ::: "memory")
__device__ __forceinline__ unsigned pk2(float lo, float hi) { return pg8::cvt_pk_bf16(lo, hi); }
__device__ __forceinline__ float bflo(unsigned w) { return __uint_as_float(w << 16); }
__device__ __forceinline__ float bfhi(unsigned w) { return __uint_as_float(w & 0xffff0000u); }

#define XB_TMO      128
#define XB_XCNT(j)  (256  + 64 * (j))
#define XB_XSUB(j)  (1280 + 64 * (j))
#define XB_XGEN(j)  (2304 + 64 * (j))
#define XB_TOP      3328
#define XB_TOPGEN   3392
#define XCD_BAR_WORDS 3456
#define XB_SPIN_CAP (1u << 18)

__device__ __forceinline__ unsigned xb_ld(unsigned* p)              { return __hip_atomic_load(p, __ATOMIC_RELAXED, __HIP_MEMORY_SCOPE_AGENT); }
__device__ __forceinline__ unsigned xb_add(unsigned* p, unsigned v) { return __hip_atomic_fetch_add(p, v, __ATOMIC_RELAXED, __HIP_MEMORY_SCOPE_AGENT); }
__device__ __forceinline__ unsigned xb_xcc_id() { return (unsigned)__builtin_amdgcn_s_getreg((3 << 11) | 20) & 0xFu; }
#define XB_SPIN(cond, bar) do { unsigned _sp = 0; while (cond) { __builtin_amdgcn_s_sleep(1); \
    if ((++_sp & 255u) == 0u) { if (xb_ld(&(bar)[XB_TMO])) break; if (_sp > XB_SPIN_CAP) { atomicAdd(&(bar)[XB_TMO], 1u); break; } } } } while (0)

struct XcdBarrier {
    unsigned* bar; unsigned x;
    volatile LAS unsigned* st;
};

__device__ __forceinline__ XcdBarrier xcd_barrier_post(unsigned* bar, volatile LAS unsigned* st) {
    XcdBarrier b; b.bar = bar; b.x = xb_xcc_id(); b.st = st;
    if (threadIdx.x == 0) (void)xb_add(&bar[XB_XCNT(b.x)], 1u);
    return b;
}
__device__ __forceinline__ void xcd_barrier_complete(unsigned* bar, unsigned x, unsigned& nloc, unsigned& nx) {
    const unsigned G = gridDim.x * gridDim.y * gridDim.z;
    unsigned sum, cnt, mine, sp = 0u;
    for (;;) {
        sum = 0u; cnt = 0u; mine = 0u;
#pragma unroll
        for (unsigned j = 0; j < 16; ++j) { const unsigned c = xb_ld(&bar[XB_XCNT(j)]); sum += c; cnt += (c > 0u) ? 1u : 0u; mine = (j == x) ? c : mine; }
        if (sum == G) break;
        __builtin_amdgcn_s_sleep(1);
        if ((++sp & 255u) == 0u) { if (xb_ld(&bar[XB_TMO])) break; if (sp > XB_SPIN_CAP) { atomicAdd(&bar[XB_TMO], 1u); break; } }
    }
    nloc = mine > 0u ? mine : 1u; nx = cnt > 0u ? cnt : 1u;
}

__device__ __forceinline__ void xcd_barrier(const XcdBarrier& b) {
    asm volatile("s_waitcnt vmcnt(0)" ::: "memory");
    __syncthreads();
    if (threadIdx.x == 0) {
        unsigned* bar = b.bar;
        __builtin_amdgcn_s_waitcnt(0);
        unsigned nloc = b.st[0], nx = b.st[1];
        if (nloc == 0u) { xcd_barrier_complete(bar, b.x, nloc, nx); b.st[0] = nloc; b.st[1] = nx; }
        const unsigned old = xb_add(&bar[XB_XSUB(b.x)], 1u);
        const unsigned gen = old / nloc;
        if (old + 1u == (gen + 1u) * nloc) {
            __builtin_amdgcn_fence(__ATOMIC_RELEASE, "agent");
            asm volatile("s_waitcnt vmcnt(0)" ::: "memory");
            const unsigned og = xb_add(&bar[XB_TOP], 1u);
            const unsigned tg = og / nx;
            if (og + 1u == (tg + 1u) * nx) xb_add(&bar[XB_TOPGEN], 1u);
            else XB_SPIN(xb_ld(&bar[XB_TOPGEN]) == tg, bar);
            __builtin_amdgcn_fence(__ATOMIC_ACQUIRE, "agent");
            xb_add(&bar[XB_XGEN(b.x)], 1u);
            asm volatile("s_waitcnt vmcnt(0)" ::: "memory");
        } else {
            XB_SPIN(xb_ld(&bar[XB_XGEN(b.x)]) == gen, bar);
            __builtin_amdgcn_fence(__ATOMIC_ACQUIRE, "agent");
            asm volatile("s_waitcnt vmcnt(0)" ::: "memory");
        }
    }
    __syncthreads();
}


struct Args { const float* in[22]; float* out; unsigned char* ws; int ph_lo, ph_hi; };
struct Frame {
    LAS unsigned char* lds; int tid, lane, wave, vcu, G;
};

__device__ __forceinline__ float wave_sum(float v) {
#pragma unroll
    for (int o = 1; o < 64; o <<= 1) v += __shfl_xor(v, o);
    return v;
}
__device__ __forceinline__ void p0_transpose_item(const float* W, int N, bf16* WT, int ldk, int koff, int rowbase, int k0, int n0, LAS float* scr, int lane) {
#pragma unroll 8
    for (int i = 0; i < 32; ++i) { const int kk = 2 * i + (lane >> 5); scr[kk * 33 + (lane & 31)] = W[(size_t)(k0 + kk) * N + n0 + (lane & 31)]; }
    LDS_WAIT(); asm volatile("" ::: "memory");
    const int c = lane & 7;
#pragma unroll
    for (int j = 0; j < 4; ++j) { const int n = (lane >> 3) + 8 * j; const LAS float* s = scr + (8 * c) * 33 + n;
        v4u o; o.x = pk2(s[0 * 33], s[1 * 33]); o.y = pk2(s[2 * 33], s[3 * 33]); o.z = pk2(s[4 * 33], s[5 * 33]); o.w = pk2(s[6 * 33], s[7 * 33]);
        *(GAS v4u*)(WT + (size_t)(rowbase + n) * ldk + koff + k0 + 8 * c) = o; }
    LDS_WAIT(); asm volatile("" ::: "memory");
}
template <int MODE>
__device__ __forceinline__ void p0_matrix(const float* W, int K, int N, bf16* WT, int ldk, int koff, int& it0, int gw, int NGW, LAS float* scr, int lane) {
    const int nblk = N / 32, nitems = (K / 64) * nblk;
    int first = gw - (it0 % NGW); if (first < 0) first += NGW;
    for (int r = first; r < nitems; r += NGW) {
        const int kb = r / nblk, nb = r % nblk, k0 = 64 * kb, n0 = 32 * nb;
        int rowbase = n0; if (MODE != 0) rowbase = (n0 >> 7) * 256 + (n0 & 127) + (MODE == 2 ? 128 : 0);
        p0_transpose_item(W, N, WT, ldk, koff, rowbase, k0, n0, scr, lane);
    }
    it0 += nitems;
}
__device__ __forceinline__ void ln_row(float* xrow, const float* g, const float* b, bf16* orow, int lane) {
    GAS f32x4* xr = (GAS f32x4*)xrow + lane;
    f32x4 v[4]; float s = 0.f;
#pragma unroll
    for (int j = 0; j < 4; ++j) { v[j] = xr[64 * j]; s += (v[j].x + v[j].y) + (v[j].z + v[j].w); }
    const float mean = wave_sum(s) * (1.f / DM); float s2 = 0.f;
#pragma unroll
    for (int j = 0; j < 4; ++j) { v[j] = v[j] - mean; s2 += (v[j].x * v[j].x + v[j].y * v[j].y) + (v[j].z * v[j].z + v[j].w * v[j].w); }
    const float rstd = 1.f / sqrtf(wave_sum(s2) * (1.f / DM) + LN_EPS);
#pragma unroll
    for (int j = 0; j < 4; ++j) { const f32x4 gg = *((const GAS f32x4*)g + lane + 64 * j), bb = *((const GAS f32x4*)b + lane + 64 * j);
        const f32x4 y = v[j] * rstd * gg + bb; xr[64 * j] = y;
        if (orow) { v2u w; w.x = pk2(y.x, y.y); w.y = pk2(y.z, y.w); *((GAS v2u*)orow + lane + 64 * j) = w; } }
}
__device__ __forceinline__ void ln_phase(Frame& F, float* X, const float* g, const float* b, bf16* OB) {
    const int gw = F.vcu * NWAVES + F.wave, NGW = F.G * NWAVES;
    for (int m = gw; m < M; m += NGW) ln_row(X + (size_t)m * DM, g, b, OB ? OB + (size_t)m * DM : nullptr, F.lane);
}

__device__ __forceinline__ int rel_bucket_small(int n) {
    int b = n;
    if (n >= 16) { b = 16; b += (n >= 19); b += (n >= 21); b += (n >= 24); b += (n >= 27); b += (n >= 31); b += (n >= 35); b += (n >= 40); b += (n >= 46); b += (n >= 52); b += (n >= 59); b += (n >= 67); b += (n >= 77); b += (n >= 87); b += (n >= 99); b += (n >= 113); }
    return b;
}

__global__ void __launch_bounds__(NTHREADS, 2) moba_fwd(Args args) {
    extern __shared__ __attribute__((aligned(16))) unsigned char lds[];
    Frame F;
    F.lds = (LAS unsigned char*)lds;
    F.tid = threadIdx.x; F.lane = F.tid & 63; F.wave = __builtin_amdgcn_readfirstlane(F.tid >> 6);
    F.G = gridDim.x; { const int bx = blockIdx.x; F.vcu = (F.G % 8 == 0) ? (bx % 8) * (F.G / 8) + bx / 8 : bx; }
    unsigned char* ws = args.ws;
    gu32* ctl = (gu32*)(ws + WS_CTL);
    const float* x = args.in[0];
    float* out = args.out;
    const int lo = args.ph_lo, hi = args.ph_hi;
#if MK_N_LAUNCHES == 1
    volatile LAS unsigned* MISC = (volatile LAS unsigned*)(F.lds + MISC_OFF);
    for (int u = F.tid; u < (LDS_BYTES - LDSCTL_OFF) / 4; u += NTHREADS) ((LAS unsigned*)(F.lds + LDSCTL_OFF))[u] = 0u;
    __syncthreads();
    XcdBarrier bar = xcd_barrier_post((unsigned*)(ctl + CW_BAR), MISC + 8);
#define GRID_BAR() xcd_barrier(bar)
#else
#define GRID_BAR() do {} while (0)
#endif
#ifndef PH_MASK
#define PH_MASK 0xFFFF
#endif
#define IN(k) (((PH_MASK >> (k)) & 1) && lo <= (k) && (k) < hi)
#define SEAM(k) do { if (IN(k) && IN((k) + 1)) GRID_BAR(); } while (0)
    const int gw = F.vcu * NWAVES + F.wave, NGW = F.G * NWAVES;

    if (IN(0)) {
        LAS float* scr = (LAS float*)(F.lds + RING_OFF + F.wave * 16384);
        int it0 = 0;
        p0_matrix<1>(args.in[1], DM, DFF, (bf16*)(ws + WS_W1A), DM, 0, it0, gw, NGW, scr, F.lane);
        p0_matrix<2>(args.in[2], DM, DFF, (bf16*)(ws + WS_W1A), DM, 0, it0, gw, NGW, scr, F.lane);
        p0_matrix<0>(args.in[3], DFF, DM, (bf16*)(ws + WS_W1D), DFF, 0, it0, gw, NGW, scr, F.lane);
        p0_matrix<0>(args.in[6], DM, NIN, (bf16*)(ws + WS_WIN), DM, 0, it0, gw, NGW, scr, F.lane);
        p0_matrix<0>(args.in[12], DM, DM, (bf16*)(ws + WS_WPAB), 2 * DM, 0, it0, gw, NGW, scr, F.lane);
        p0_matrix<0>(args.in[13], DM, DM, (bf16*)(ws + WS_WPAB), 2 * DM, DM, it0, gw, NGW, scr, F.lane);
        p0_matrix<0>(args.in[14], DM, DM, (bf16*)(ws + WS_WOUT), DM, 0, it0, gw, NGW, scr, F.lane);
        p0_matrix<1>(args.in[17], DM, DFF, (bf16*)(ws + WS_W2A), DM, 0, it0, gw, NGW, scr, F.lane);
        p0_matrix<2>(args.in[18], DM, DFF, (bf16*)(ws + WS_W2A), DM, 0, it0, gw, NGW, scr, F.lane);
        p0_matrix<0>(args.in[19], DFF, DM, (bf16*)(ws + WS_W2D), DFF, 0, it0, gw, NGW, scr, F.lane);
        {
            const float* Wsrc = args.in[9]; bf16* Wst = (bf16*)(ws + WS_WST);
            const int gt = F.vcu * NTHREADS + F.tid, NGT = F.G * NTHREADS;
            for (int i = gt; i < 8 * 128 * 128 / 8; i += NGT) { const int e = i * 8, t = (e >> 7) & 127, s0 = e & 127;
                const f32x4 a = *(const GAS f32x4*)(Wsrc + e), b = *(const GAS f32x4*)(Wsrc + e + 4);
                float v[8] = {a.x, a.y, a.z, a.w, b.x, b.y, b.z, b.w};
#pragma unroll
                for (int j = 0; j < 8; ++j) v[j] = (s0 + j <= t) ? v[j] : 0.f;
                v4u o; o.x = pk2(v[0], v[1]); o.y = pk2(v[2], v[3]); o.z = pk2(v[4], v[5]); o.w = pk2(v[6], v[7]);
                *(GAS v4u*)(Wst + e) = o; }
            bf16* XB = (bf16*)(ws + WS_XB);
            for (size_t i = gt; i < (size_t)M * DM / 8; i += NGT) { const size_t e = i * 8;
                const f32x4 a = *(const GAS f32x4*)(x + e), b = *(const GAS f32x4*)(x + e + 4);
                v4u o; o.x = pk2(a.x, a.y); o.y = pk2(a.z, a.w); o.z = pk2(b.x, b.y); o.w = pk2(b.z, b.w);
                *(GAS v4u*)(XB + e) = o; }
        }
    }
    SEAM(0);
    if (IN(1)) {
        pg8::Gemm g{(const bf16*)(ws + WS_XB), (const bf16*)(ws + WS_W1A), M, 2 * DFF, DM}; pg8::StaticOrder S; S.init(M, 2 * DFF, F.G, (int)blockIdx.x);
        pg8::EpiSwiGLU E{(bf16*)(ws + WS_HID1), DFF};
        pg8::gemm_phase<pg8::EpiSwiGLU, pg8::StaticOrder, true, true>(F.lds + RING_OFF, g, S, E);
    }
    SEAM(1);
    if (IN(2)) {
        pg8::Gemm g{(const bf16*)(ws + WS_HID1), (const bf16*)(ws + WS_W1D), M, DM, DFF}; pg8::StaticOrder S; S.init(M, DM, F.G, (int)blockIdx.x);
        pg8::EpiRes E{x, out, DM, ALPHA, 0.5f};
        pg8::gemm_phase<pg8::EpiRes, pg8::StaticOrder, true, true>(F.lds + RING_OFF, g, S, E);
    }
    SEAM(2);
    if (IN(3)) ln_phase(F, out, args.in[4], args.in[5], (bf16*)(ws + WS_H1B));
    SEAM(3);
    if (IN(4)) {
        pg8::Gemm g{(const bf16*)(ws + WS_H1B), (const bf16*)(ws + WS_WIN), M, NIN_A, DM}; pg8::StaticOrder S; S.init(M, NIN_A, F.G, (int)blockIdx.x);
        pg8::EpiInA E{(bf16*)(ws + WS_YAB), 2 * DM, (bf16*)(ws + WS_VB), DM, (pg8::f32x2*)(ws + WS_STATS)};
        pg8::gemm_phase<pg8::EpiInA, pg8::StaticOrder, true, true>(F.lds + RING_OFF, g, S, E);
    }
    SEAM(4);
    if (IN(5)) {
        const bf16* Wst = (const bf16*)(ws + WS_WST); const bf16* VBp = (const bf16*)(ws + WS_VB); bf16* YAB = (bf16*)(ws + WS_YAB);
        const f32x2* stats = (const f32x2*)(ws + WS_STATS);
        const float* lng = args.in[7]; const float* lnb = args.in[8]; const float* bs = args.in[10];
        char* Vt = (char*)lds;
        LAS f32x2* stat = (LAS f32x2*)(F.lds + 32768);
        const int lane = F.lane, r32 = lane & 31, hi5 = lane >> 5, wid = F.wave;
        const int sr = F.tid >> 4, sc = (F.tid & 15) * 8;
        const int rb = wid & 3, dh = wid >> 2;
        const int vb0 = (int)(uintptr_t)Vt + moba::v_rd_base(lane) + dh * 1024;
        for (int ch = F.vcu; ch < M / 128; ch += F.G) {
            const int R0 = ch * 128;
            __syncthreads();
            if (F.tid < 128) { const f32x2* sp = stats + (size_t)(R0 + F.tid) * 16; float s = 0.f, q = 0.f;
#pragma unroll
                for (int j = 0; j < 16; ++j) { const f32x2 p = sp[j]; s += p.x; q += p.y; }
                const float mean = s * (1.f / 1024.f); const float var = fmaxf(q * (1.f / 1024.f) - mean * mean, 0.f);
                stat[F.tid] = (f32x2){mean, 1.f / sqrtf(var + LN_EPS)}; }
            __syncthreads();
            for (int g = 0; g < 8; ++g) {
                const int cg = g * 128 + sc;
                const f32x4 ga = *(const GAS f32x4*)(lng + cg), gb = *(const GAS f32x4*)(lng + cg + 4), ba = *(const GAS f32x4*)(lnb + cg), bb = *(const GAS f32x4*)(lnb + cg + 4);
#pragma unroll
                for (int T = 0; T < 2; ++T)
#pragma unroll
                    for (int hf = 0; hf < 2; ++hf) { const int row = 64 * T + 32 * hf + sr;
                        const v4u raw = *(const GAS v4u*)(VBp + (size_t)(R0 + row) * DM + cg); const f32x2 ms = stat[row];
                        v4u o;
                        o.x = pk2((bflo(raw.x) - ms.x) * ms.y * ga.x + ba.x, (bfhi(raw.x) - ms.x) * ms.y * ga.y + ba.y);
                        o.y = pk2((bflo(raw.y) - ms.x) * ms.y * ga.z + ba.z, (bfhi(raw.y) - ms.x) * ms.y * ga.w + ba.w);
                        o.z = pk2((bflo(raw.z) - ms.x) * ms.y * gb.x + bb.x, (bfhi(raw.z) - ms.x) * ms.y * gb.y + bb.y);
                        o.w = pk2((bflo(raw.w) - ms.x) * ms.y * gb.z + bb.z, (bfhi(raw.w) - ms.x) * ms.y * gb.w + bb.w);
                        *(v4u*)(Vt + T * 16384 + moba::v_st(32 * hf + sr, sc)) = o; }
                __syncthreads();
                f32x16 o0 = {}, o1 = {};
                const bf16* wrow = Wst + ((size_t)(g * 128 + 32 * rb + r32) * 128 + 8 * hi5);
                {
                    const bf16x8 pa0 = *(const bf16x8*)(wrow + 0), pa1 = *(const bf16x8*)(wrow + 16), pa2 = *(const bf16x8*)(wrow + 32), pa3 = *(const bf16x8*)(wrow + 48);
                    MOBA_PV_D0(o0, vb0, 0, 0); MOBA_PV_D0(o1, vb0, 0, 1);
                }
                if (rb >= 2) {
                    const bf16x8 pa0 = *(const bf16x8*)(wrow + 64), pa1 = *(const bf16x8*)(wrow + 80), pa2 = *(const bf16x8*)(wrow + 96), pa3 = *(const bf16x8*)(wrow + 112);
                    MOBA_PV_D0(o0, vb0, 16384, 0); MOBA_PV_D0(o1, vb0, 16384, 1);
                }
#pragma unroll
                for (int r = 0; r < 16; ++r) { const int t = 32 * rb + moba::crow(r, hi5); const float bst = bs[g * 128 + t];
                    bf16* up = YAB + (size_t)(R0 + t) * (2 * DM) + g * 128 + dh * 64 + r32;
                    const float u0 = __uint_as_float((unsigned)up[0] << 16), u1 = __uint_as_float((unsigned)up[32] << 16);
                    up[0] = (bf16)(pk2(u0 * (o0[r] + bst), 0.f) & 0xffffu); up[32] = (bf16)(pk2(u1 * (o1[r] + bst), 0.f) & 0xffffu); }
                __syncthreads();
            }
        }
    }
    SEAM(5);
    if (IN(6)) {
        pg8::Gemm g{(const bf16*)(ws + WS_H1B), (const bf16*)(ws + WS_WIN) + (size_t)NIN_A * DM, M, NIN_B, DM}; pg8::StaticOrder S; S.init(M, NIN_B, F.G, (int)blockIdx.x);
        pg8::EpiInB E{(bf16*)(ws + WS_YAB) + DM, 2 * DM, (bf16*)(ws + WS_KB), (bf16*)(ws + WS_VMB), (bf16*)(ws + WS_GA), (bf16*)(ws + WS_GB), DM};
        pg8::gemm_phase<pg8::EpiInB, pg8::StaticOrder, true, true>(F.lds + RING_OFF, g, S, E);
    }
    SEAM(6);
    if (IN(7)) {
        const bf16* KBp = (const bf16*)(ws + WS_KB); float* kmean = (float*)(ws + WS_KMEAN);
        const int cc = (F.lane & 15) * 8, rg = F.lane >> 4;
        for (int it = gw; it < BATCH * NBLK * NHEAD; it += NGW) { const int h = it & 7, j = (it >> 3) & 15, b = it >> 7;
            const bf16* p = KBp + ((size_t)(b * SEQ + j * MBLK + rg)) * DM + h * HD + cc;
            float a[8] = {0.f, 0.f, 0.f, 0.f, 0.f, 0.f, 0.f, 0.f};
#pragma unroll 8
            for (int i = 0; i < 64; ++i) { const v4u w = *(const GAS v4u*)(p + (size_t)(4 * i) * DM);
                a[0] += bflo(w.x); a[1] += bfhi(w.x); a[2] += bflo(w.y); a[3] += bfhi(w.y); a[4] += bflo(w.z); a[5] += bfhi(w.z); a[6] += bflo(w.w); a[7] += bfhi(w.w); }
#pragma unroll
            for (int e = 0; e < 8; ++e) { a[e] += __shfl_xor(a[e], 16); a[e] += __shfl_xor(a[e], 32); a[e] *= (1.f / 256.f); }
            if (rg == 0) { float* o = kmean + ((size_t)((b * NHEAD + h) * NBLK + j)) * HD + cc;
                *(GAS f32x4*)o = (f32x4){a[0], a[1], a[2], a[3]}; *(GAS f32x4*)(o + 4) = (f32x4){a[4], a[5], a[6], a[7]}; } }
    }
    SEAM(7);
    if (IN(8)) {
        const bf16* Qp = (const bf16*)(ws + WS_YAB) + DM; const float* kmean = (const float*)(ws + WS_KMEAN); unsigned* sel = (unsigned*)(ws + WS_SEL);
        LAS float* km = (LAS float*)(F.lds);
        for (int it = F.vcu; it < BATCH * NHEAD * (SEQ / NTHREADS); it += F.G) { const int chunk = it & 7, bh = it >> 3, b = bh >> 3, h = bh & 7;
            __syncthreads();
            for (int i = F.tid; i < NBLK * HD; i += NTHREADS) km[i] = kmean[(size_t)bh * NBLK * HD + i];
            __syncthreads();
            const int s = chunk * NTHREADS + F.tid, qb = s >> 8;
            unsigned mask = 0u;
            if (qb > 0) {
                const bf16* qp = Qp + (size_t)(b * SEQ + s) * (2 * DM) + h * HD;
                float gate[15];
#pragma unroll
                for (int j = 0; j < 15; ++j) gate[j] = 0.f;
                for (int d0 = 0; d0 < HD; d0 += 8) { const v4u w = *(const GAS v4u*)(qp + d0);
                    const float q[8] = {bflo(w.x), bfhi(w.x), bflo(w.y), bfhi(w.y), bflo(w.z), bfhi(w.z), bflo(w.w), bfhi(w.w)};
#pragma unroll
                    for (int j = 0; j < 15; ++j) { const f32x4 k0 = *(const LAS f32x4*)(km + j * HD + d0), k1 = *(const LAS f32x4*)(km + j * HD + d0 + 4);
                        gate[j] += q[0] * k0.x + q[1] * k0.y + q[2] * k0.z + q[3] * k0.w + q[4] * k1.x + q[5] * k1.y + q[6] * k1.z + q[7] * k1.w; } }
                float v0 = -3e38f, v1 = -3e38f, v2 = -3e38f; int i0 = -1, i1 = -1, i2 = -1;
#pragma unroll
                for (int j = 0; j < 15; ++j) { if (j < qb) { const float gj = gate[j];
                    if (gj > v0) { v2 = v1; i2 = i1; v1 = v0; i1 = i0; v0 = gj; i0 = j; }
                    else if (gj > v1) { v2 = v1; i2 = i1; v1 = gj; i1 = j; }
                    else if (gj > v2) { v2 = gj; i2 = j; } } }
                if (i0 >= 0) mask |= 1u << i0; if (i1 >= 0) mask |= 1u << i1; if (i2 >= 0) mask |= 1u << i2;
            }
            sel[(size_t)bh * SEQ + s] = mask;
        }
    }
    SEAM(8);
    if (IN(9)) {
        const float* table = args.in[11];
        {
            float* lut = (float*)((char*)lds + moba::LDS_LUT);
            for (int i = F.tid; i < 8 * 128; i += NTHREADS) { const int h = i >> 7, d = i & 127;
                lut[i] = d < 113 ? (table[rel_bucket_small(d) * 8 + h] - table[31 * 8 + h]) * (1.0f / moba::SCALE) : 0.f; }
            __syncthreads();
        }
        bf16* YB = (bf16*)(ws + WS_YAB) + DM; const bf16* KBp = (const bf16*)(ws + WS_KB); const bf16* VMp = (const bf16*)(ws + WS_VMB); const unsigned* sel = (const unsigned*)(ws + WS_SEL);
        const int total = BATCH * NHEAD * 8;
        int L = F.vcu;
        if (L < total) {
#define MOBA_REF(r_, L_, pass_) do { const int bh_ = (L_) >> 3, x_ = (L_) & 7, qb_ = (pass_) ? 15 - x_ : x_, b_ = bh_ >> 3, h_ = bh_ & 7;                        \
            r_.Q = YB + ((size_t)(b_ * SEQ + qb_ * MBLK)) * (2 * DM) + h_ * HD; r_.O = YB + ((size_t)(b_ * SEQ + qb_ * MBLK)) * (2 * DM) + h_ * HD;                \
            r_.K = KBp + (size_t)(b_ * SEQ) * DM + h_ * HD; r_.V = VMp + (size_t)(b_ * SEQ) * DM + h_ * HD; r_.sel = sel + (size_t)bh_ * SEQ + qb_ * MBLK;        \
            r_.P0 = qb_ * MBLK; r_.h = h_; } while (0)
            moba::BlockRef cur, nxt; int pass = 0;
            MOBA_REF(cur, L, 0);
            moba::Seam S;
            moba::moba_prime(cur, (char*)lds, S);
            for (;;) {
                const bool more_pass = pass == 0, more_item = L + F.G < total, last = !more_pass && !more_item;
                int passn = pass + 1, Ln = L;
                if (!more_pass) { passn = 0; Ln = more_item ? L + F.G : L; }
                if (last) nxt = cur; else MOBA_REF(nxt, Ln, passn);
                moba::moba_block(cur, nxt, (char*)lds, S);
                if (last) break;
                cur = nxt; pass = passn; L = Ln;
            }
#undef MOBA_REF
        }
    }
    SEAM(9);
    if (IN(10)) {
        pg8::Gemm g{(const bf16*)(ws + WS_YAB), (const bf16*)(ws + WS_WPAB), M, DM, 2 * DM}; pg8::StaticOrder S; S.init(M, DM, F.G, (int)blockIdx.x);
        pg8::EpiMerge E{(const bf16*)(ws + WS_GA), (const bf16*)(ws + WS_GB), (bf16*)(ws + WS_MRG), DM};
        pg8::gemm_phase<pg8::EpiMerge, pg8::StaticOrder, true, true, 16>(F.lds + RING_OFF, g, S, E);
    }
    SEAM(10);
    if (IN(11)) {
        pg8::Gemm g{(const bf16*)(ws + WS_MRG), (const bf16*)(ws + WS_WOUT), M, DM, DM}; pg8::StaticOrder S; S.init(M, DM, F.G, (int)blockIdx.x);
        pg8::EpiRes E{out, out, DM, ALPHA, 1.0f};
        pg8::gemm_phase<pg8::EpiRes, pg8::StaticOrder, true, true>(F.lds + RING_OFF, g, S, E);
    }
    SEAM(11);
    if (IN(12)) ln_phase(F, out, args.in[15], args.in[16], (bf16*)(ws + WS_H2B));
    SEAM(12);
    if (IN(13)) {
        pg8::Gemm g{(const bf16*)(ws + WS_H2B), (const bf16*)(ws + WS_W2A), M, 2 * DFF, DM}; pg8::StaticOrder S; S.init(M, 2 * DFF, F.G, (int)blockIdx.x);
        pg8::EpiSwiGLU E{(bf16*)(ws + WS_HID2), DFF};
        pg8::gemm_phase<pg8::EpiSwiGLU, pg8::StaticOrder, true, true>(F.lds + RING_OFF, g, S, E);
    }
    SEAM(13);
    if (IN(14)) {
        pg8::Gemm g{(const bf16*)(ws + WS_HID2), (const bf16*)(ws + WS_W2D), M, DM, DFF}; pg8::StaticOrder S; S.init(M, DM, F.G, (int)blockIdx.x);
        pg8::EpiRes E{out, out, DM, ALPHA, 0.5f};
        pg8::gemm_phase<pg8::EpiRes, pg8::StaticOrder, true, true>(F.lds + RING_OFF, g, S, E);
    }
    SEAM(14);
    if (IN(15)) ln_phase(F, out, args.in[20], args.in[21], nullptr);
#undef IN
#undef SEAM
}

extern "C" void kernel_launch(void* const* d_in, const int* in_sizes, int n_in, void* d_out, int out_size, void* d_ws, size_t ws_size, hipStream_t stream) {
    static int grid = 0;
    if (grid == 0) {
        if (n_in != 22 || in_sizes[0] != M * DM || out_size != M * DM || ws_size < WS_END) { fprintf(stderr, "kernel_launch: unexpected shapes (n_in %d, in0 %d, out %d, ws %zu)\n", n_in, n_in > 0 ? in_sizes[0] : -1, out_size, ws_size); grid = -1; return; }
        int dev = 0, cus = 0, per_cu = 0;
        if (hipGetDevice(&dev) != hipSuccess || hipDeviceGetAttribute(&cus, hipDeviceAttributeMultiprocessorCount, dev) != hipSuccess) { grid = -1; return; }
        if (hipFuncSetAttribute((const void*)moba_fwd, hipFuncAttributeMaxDynamicSharedMemorySize, LDS_BYTES) != hipSuccess) { fprintf(stderr, "kernel_launch: hipFuncSetAttribute failed\n"); grid = -1; return; }
        if (hipOccupancyMaxActiveBlocksPerMultiprocessor(&per_cu, (const void*)moba_fwd, NTHREADS, LDS_BYTES) != hipSuccess || per_cu < 1) { fprintf(stderr, "kernel_launch: occupancy query says %d\n", per_cu); per_cu = 1; }
        (void)hipGetLastError();
        grid = cus;
        if (grid != 256) fprintf(stderr, "kernel_launch: %d CUs (built for 256)\n", grid);
    }
    if (grid < 0) return;
    (void)hipMemsetAsync((char*)d_ws + WS_CTL, 0, CTL_ZERO_BYTES, stream);
    Args a{};
    for (int i = 0; i < 22; ++i) a.in[i] = (const float*)d_in[i];
    a.out = (float*)d_out; a.ws = (unsigned char*)d_ws;
#if MK_N_LAUNCHES == 1
    a.ph_lo = 0; a.ph_hi = NPH;
    void* kargs[] = {&a};
    hipError_t e = hipLaunchCooperativeKernel((const void*)moba_fwd, dim3(grid), dim3(NTHREADS), kargs, LDS_BYTES, stream);
    if (e != hipSuccess) fprintf(stderr, "kernel_launch: cooperative launch failed: %s\n", hipGetErrorString(e));
#else
    for (int p = 0; p < NPH; ++p) { a.ph_lo = p; a.ph_hi = p + 1;
        hipLaunchKernelGGL(moba_fwd, dim3(grid), dim3(NTHREADS), LDS_BYTES, stream, a); }
#endif
}
```
